# Optimizing an MI355X kernel written in HIP

```python
import math
import jax, jax.numpy as jnp
from jax import lax
import numpy as np

D_MODEL = 1024
BATCH = 8
SEQ = 4096
DEPTH = 1

SWA_HEAD_DIM = 64
SWA_HEADS = (D_MODEL // 2) // SWA_HEAD_DIM
SWA_WIDTH = SWA_HEADS * SWA_HEAD_DIM
SWA_PATTERNS = ((128, 1), (512, 4), (2048, 16))
SWA_ROT_DIM = SWA_HEAD_DIM // 4
MLA_NOPE_DIM = 128
MLA_ROPE_DIM = 64
MLA_V_DIM = 128
MLA_QK_DIM = MLA_NOPE_DIM + MLA_ROPE_DIM
MLA_HEADS = (D_MODEL // 2) // MLA_V_DIM
MLA_WIDTH = MLA_HEADS * MLA_V_DIM
MLA_Q_RANK = D_MODEL // 4
MLA_KV_RANK = D_MODEL // 8
Q_BLOCK = 128
MIX_WIDTH = SWA_WIDTH + MLA_WIDTH
IN_SPLITS = (SWA_WIDTH, 2 * SWA_WIDTH, 3 * SWA_WIDTH,
             3 * SWA_WIDTH + MLA_Q_RANK,
             3 * SWA_WIDTH + MLA_Q_RANK + MLA_KV_RANK)
IN_WIDTH = 3 * SWA_WIDTH + MLA_Q_RANK + MLA_KV_RANK + MLA_ROPE_DIM
D_FF = 2816
CONV_WIDTH = 3
ROPE_THETA = 500000.0
LN_EPS = 1e-5
RMS_EPS = 1e-6
NEG_INF = -1e30
DEEPNORM_ALPHA = (2.0 * DEPTH) ** 0.25
DEEPNORM_BETA = (8.0 * DEPTH) ** -0.25

kernel_name = 'hybrid_dilated_swa_mla_convffn_deepnorm'


def layer_norm(x, g, b):
    xf = x.astype(jnp.float32)
    mu = jnp.mean(xf, axis=-1, keepdims=True)
    xc = xf - mu
    var = jnp.mean(xc * xc, axis=-1, keepdims=True)
    y = xc * lax.rsqrt(var + LN_EPS) * g.astype(jnp.float32) + b.astype(jnp.float32)
    return y.astype(x.dtype)


def rms_norm(x, g, out_dtype):
    xf = x.astype(jnp.float32)
    y = xf * lax.rsqrt(jnp.mean(xf * xf, axis=-1, keepdims=True) + RMS_EPS) * g.astype(jnp.float32)
    return y.astype(out_dtype)


def rope(x, positions, rot_dim):
    half = rot_dim // 2
    inv_freq = jnp.power(jnp.float32(ROPE_THETA),
                         -jnp.arange(half, dtype=jnp.float32) * (2.0 / rot_dim))
    ang = positions.astype(jnp.float32)[:, :, None] * inv_freq
    cos = jnp.cos(ang)[:, :, None, :]
    sin = jnp.sin(ang)[:, :, None, :]
    xr = x[..., :rot_dim].astype(jnp.float32)
    x1, x2 = xr[..., :half], xr[..., half:]
    rot = jnp.concatenate([x1 * cos - x2 * sin, x2 * cos + x1 * sin], axis=-1).astype(x.dtype)
    return jnp.concatenate([rot, x[..., rot_dim:]], axis=-1)


def dilated_band_attention(q, k, v, dilation, n_side):
    B, S, H, Dh = q.shape
    L = S // dilation
    blk = math.gcd(L, n_side)
    nblk = L // blk
    span = blk + 2 * n_side

    def to_residue(t):
        return t.reshape(B, L, dilation, H, Dh).transpose(0, 2, 1, 3, 4).reshape(B * dilation, L, H, Dh)

    def from_residue(t):
        tail = t.shape[3:]
        t = t.reshape((B, dilation, L) + tail)
        t = t.transpose((0, 2, 1) + tuple(range(3, t.ndim)))
        return t.reshape((B, S) + tail)

    qr = to_residue(q).reshape(B * dilation, nblk, blk, H, Dh).astype(jnp.float32)
    pad = ((0, 0), (n_side, n_side), (0, 0), (0, 0))
    kp = jnp.pad(to_residue(k), pad)
    vp = jnp.pad(to_residue(v), pad)
    key_idx = jnp.arange(nblk)[:, None] * blk + jnp.arange(span)[None, :]
    kb = kp[:, key_idx].astype(jnp.float32)
    vb = vp[:, key_idx].astype(jnp.float32)
    q_pos = jnp.arange(nblk)[:, None] * blk + jnp.arange(blk)[None, :]
    k_pos = key_idx - n_side
    valid = ((jnp.abs(q_pos[:, :, None] - k_pos[:, None, :]) <= n_side)
             & (k_pos[:, None, :] >= 0) & (k_pos[:, None, :] < L))

    s = jnp.einsum('znqhd,znkhd->znhqk', qr, kb) * (Dh ** -0.5)
    s = jnp.where(valid[None, :, None, :, :], s, NEG_INF)
    m = jnp.max(s, axis=-1, keepdims=True)
    p = jnp.exp(s - m)
    den = jnp.sum(p, axis=-1)
    o = jnp.einsum('znhqk,znkhd->znqhd', p, vb)
    o = o / den.transpose(0, 1, 3, 2)[..., None]
    lse = (m[..., 0] + jnp.log(den)).transpose(0, 1, 3, 2)
    return from_residue(o), from_residue(lse)


def dilated_mixture_attention(q, k, v):
    outs, lses = [], []
    for window, dilation in SWA_PATTERNS:
        o, lse = dilated_band_attention(q, k, v, dilation, window // (2 * dilation))
        outs.append(o)
        lses.append(lse)
    w = jax.nn.softmax(jnp.stack(lses, axis=0), axis=0)
    return jnp.einsum('pbsh,pbshd->bshd', w, jnp.stack(outs, axis=0))


def mla_attention(q, k, v):
    B, S, H, Dq = q.shape
    nb = S // Q_BLOCK
    qb = q.reshape(B, nb, Q_BLOCK, H, Dq).transpose(1, 0, 2, 3, 4)
    kf = k.astype(jnp.float32)
    vf = v.astype(jnp.float32)
    scale = Dq ** -0.5

    def block(qi):
        s = jnp.einsum('bqhd,bkhd->bhqk', qi.astype(jnp.float32), kf) * scale
        p = jax.nn.softmax(s, axis=-1)
        return jnp.einsum('bhqk,bkhd->bqhd', p, vf)

    o = lax.map(block, qb)
    return o.transpose(1, 0, 2, 3, 4).reshape(B, S, H, v.shape[-1])


def hybrid_layer(x, positions, w_in, q_norm_g, w_uq, kv_norm_g, w_ukv, out_norm_g, w_o,
                 ln1_g, ln1_b, w_up, conv_w, conv_b, w_down, ln2_g, ln2_b):
    B, S, _ = x.shape
    dt = x.dtype
    h = x @ w_in
    q_a, k_a, v_a, c_q, c_kv, k_rope = jnp.split(h, list(IN_SPLITS), axis=-1)

    q_a = rope(q_a.reshape(B, S, SWA_HEADS, SWA_HEAD_DIM), positions, SWA_ROT_DIM)
    k_a = rope(k_a.reshape(B, S, SWA_HEADS, SWA_HEAD_DIM), positions, SWA_ROT_DIM)
    v_a = v_a.reshape(B, S, SWA_HEADS, SWA_HEAD_DIM)
    o_a = dilated_mixture_attention(q_a, k_a, v_a).reshape(B, S, SWA_WIDTH)

    q_b = (rms_norm(c_q, q_norm_g, dt) @ w_uq).reshape(B, S, MLA_HEADS, MLA_QK_DIM)
    q_nope, q_pe = q_b[..., :MLA_NOPE_DIM], q_b[..., MLA_NOPE_DIM:]
    q_pe = rope(q_pe, positions, MLA_ROPE_DIM)
    kv = (rms_norm(c_kv, kv_norm_g, dt) @ w_ukv).reshape(B, S, MLA_HEADS, MLA_NOPE_DIM + MLA_V_DIM)
    k_nope, v_b = kv[..., :MLA_NOPE_DIM], kv[..., MLA_NOPE_DIM:]
    k_pe = rope(k_rope[:, :, None, :], positions, MLA_ROPE_DIM)
    k_pe = jnp.broadcast_to(k_pe, (B, S, MLA_HEADS, MLA_ROPE_DIM))
    q_full = jnp.concatenate([q_nope, q_pe], axis=-1)
    k_full = jnp.concatenate([k_nope, k_pe], axis=-1)
    o_b = mla_attention(q_full, k_full, v_b).reshape(B, S, MLA_WIDTH)

    o = jnp.concatenate([rms_norm(o_a, out_norm_g[:SWA_WIDTH], dt),
                         rms_norm(o_b, out_norm_g[SWA_WIDTH:], dt)], axis=-1)
    x = layer_norm(DEEPNORM_ALPHA * x + o @ w_o, ln1_g, ln1_b)

    u = x @ w_up
    half = CONV_WIDTH // 2
    up = jnp.pad(u, ((0, 0), (half, half), (0, 0)))
    uc = conv_b
    for t in range(CONV_WIDTH):
        uc = uc + up[:, t:t + S] * conv_w[t]
    gate, val = uc[..., :D_FF], uc[..., D_FF:]
    y = (jax.nn.silu(gate) * val) @ w_down
    x = layer_norm(DEEPNORM_ALPHA * x + y, ln2_g, ln2_b)
    return x


def setup_inputs(seed: int = 0) -> dict:
    key = jax.random.key(seed)
    ks = jax.random.split(key, 24)
    f32 = jnp.float32
    beta = DEEPNORM_BETA

    def nrm(k, shape, scale):
        return jax.random.normal(k, shape, f32) * scale

    def gain(k, n):
        return 1.0 + 0.02 * jax.random.normal(k, (DEPTH, n), f32)

    x = jax.random.normal(ks[0], (BATCH, SEQ, D_MODEL), f32)
    offsets = jax.random.randint(ks[1], (BATCH, 1), 0, 1024, dtype=jnp.int32)
    positions = (jnp.arange(SEQ, dtype=jnp.int32)[None, :] + offsets).astype(jnp.int32)

    ln_emb_g = 1.0 + 0.02 * jax.random.normal(ks[2], (D_MODEL,), f32)
    ln_emb_b = 0.02 * jax.random.normal(ks[3], (D_MODEL,), f32)

    in_col_scale = jnp.concatenate([
        jnp.ones((2 * SWA_WIDTH,), f32), jnp.full((SWA_WIDTH,), beta, f32),
        jnp.ones((MLA_Q_RANK + MLA_KV_RANK + MLA_ROPE_DIM,), f32)])
    w_in = nrm(ks[4], (DEPTH, D_MODEL, IN_WIDTH), D_MODEL ** -0.5) * in_col_scale
    q_norm_g = gain(ks[5], MLA_Q_RANK)
    w_uq = nrm(ks[6], (DEPTH, MLA_Q_RANK, MLA_HEADS * MLA_QK_DIM), MLA_Q_RANK ** -0.5)
    kv_norm_g = gain(ks[7], MLA_KV_RANK)
    ukv_scale = jnp.tile(jnp.concatenate([jnp.ones((MLA_NOPE_DIM,), f32),
                                          jnp.full((MLA_V_DIM,), beta, f32)]), MLA_HEADS)
    w_ukv = nrm(ks[8], (DEPTH, MLA_KV_RANK, MLA_HEADS * (MLA_NOPE_DIM + MLA_V_DIM)),
                MLA_KV_RANK ** -0.5) * ukv_scale
    out_norm_g = gain(ks[9], MIX_WIDTH)
    w_o = nrm(ks[10], (DEPTH, MIX_WIDTH, D_MODEL), beta * MIX_WIDTH ** -0.5)
    ln1_g = gain(ks[11], D_MODEL)
    ln1_b = 0.02 * jax.random.normal(ks[12], (DEPTH, D_MODEL), f32)
    w_up = nrm(ks[13], (DEPTH, D_MODEL, 2 * D_FF), beta * D_MODEL ** -0.5)
    conv_w = nrm(ks[14], (DEPTH, CONV_WIDTH, 2 * D_FF), CONV_WIDTH ** -0.5)
    conv_b = 0.01 * jax.random.normal(ks[15], (DEPTH, 2 * D_FF), f32)
    w_down = nrm(ks[16], (DEPTH, D_FF, D_MODEL), beta * D_FF ** -0.5)
    ln2_g = gain(ks[17], D_MODEL)
    ln2_b = 0.02 * jax.random.normal(ks[18], (DEPTH, D_MODEL), f32)
    return {'x': x, 'positions': positions, 'ln_emb_g': ln_emb_g, 'ln_emb_b': ln_emb_b,
            'w_in': w_in, 'q_norm_g': q_norm_g, 'w_uq': w_uq, 'kv_norm_g': kv_norm_g,
            'w_ukv': w_ukv, 'out_norm_g': out_norm_g, 'w_o': w_o, 'ln1_g': ln1_g, 'ln1_b': ln1_b,
            'w_up': w_up, 'conv_w': conv_w, 'conv_b': conv_b, 'w_down': w_down,
            'ln2_g': ln2_g, 'ln2_b': ln2_b}


def reference(x, positions, ln_emb_g, ln_emb_b, w_in, q_norm_g, w_uq, kv_norm_g, w_ukv,
              out_norm_g, w_o, ln1_g, ln1_b, w_up, conv_w, conv_b, w_down, ln2_g, ln2_b):
    x = layer_norm(x, ln_emb_g, ln_emb_b)
    for l in range(DEPTH):
        x = hybrid_layer(x, positions, w_in[l], q_norm_g[l], w_uq[l], kv_norm_g[l], w_ukv[l],
                         out_norm_g[l], w_o[l], ln1_g[l], ln1_b[l], w_up[l], conv_w[l],
                         conv_b[l], w_down[l], ln2_g[l], ln2_b[l])
    return x
```

```cpp
#include <hip/hip_runtime.h>
#include <cstdio>
#include <cstdint>

constexpr int NB = 8, S = 4096, D = 1024, M = NB * S;
constexpr int INW = 1984, FF = 2816, FF2 = 2 * FF;
constexpr float LN_EPS = 1e-5f, RMS_EPS = 1e-6f;
constexpr float ALPHA = 1.189207115002721f;
constexpr float LOG2_THETA = 18.931568569324174f;

__global__ void __launch_bounds__(256) gemm_f32(const float* __restrict__ A, int lda, const float* __restrict__ Bm, int ldb, float* __restrict__ C, int ldc, int K) {
    __shared__ float As[16][65];
    __shared__ float Bs[16][64];
    const int tx = threadIdx.x & 15, ty = threadIdx.x >> 4;
    const int m0 = blockIdx.y * 64, n0 = blockIdx.x * 64;
    float acc[4][4];
#pragma unroll
    for (int i = 0; i < 4; ++i)
#pragma unroll
        for (int j = 0; j < 4; ++j) acc[i][j] = 0.f;
    for (int k0 = 0; k0 < K; k0 += 16) {
        {
            const int r = threadIdx.x >> 2, c4 = (threadIdx.x & 3) * 4;
            const float4 v = *(const float4*)(A + (size_t)(m0 + r) * lda + k0 + c4);
            As[c4 + 0][r] = v.x; As[c4 + 1][r] = v.y; As[c4 + 2][r] = v.z; As[c4 + 3][r] = v.w;
        }
        {
            const int r = threadIdx.x >> 4, c4 = (threadIdx.x & 15) * 4;
            const float4 v = *(const float4*)(Bm + (size_t)(k0 + r) * ldb + n0 + c4);
            *(float4*)&Bs[r][c4] = v;
        }
        __syncthreads();
#pragma unroll
        for (int kk = 0; kk < 16; ++kk) {
            float a[4], b[4];
#pragma unroll
            for (int i = 0; i < 4; ++i) a[i] = As[kk][ty * 4 + i];
#pragma unroll
            for (int j = 0; j < 4; ++j) b[j] = Bs[kk][tx * 4 + j];
#pragma unroll
            for (int i = 0; i < 4; ++i)
#pragma unroll
                for (int j = 0; j < 4; ++j) acc[i][j] = fmaf(a[i], b[j], acc[i][j]);
        }
        __syncthreads();
    }
#pragma unroll
    for (int i = 0; i < 4; ++i) {
        float4 v = {acc[i][0], acc[i][1], acc[i][2], acc[i][3]};
        *(float4*)(C + (size_t)(m0 + ty * 4 + i) * ldc + n0 + tx * 4) = v;
    }
}

__device__ __forceinline__ float block_sum(float v, float* red) {
#pragma unroll
    for (int o = 32; o > 0; o >>= 1) v += __shfl_xor(v, o);
    const int w = threadIdx.x >> 6;
    __syncthreads();
    if ((threadIdx.x & 63) == 0) red[w] = v;
    __syncthreads();
    return red[0] + red[1] + red[2] + red[3];
}

__global__ void __launch_bounds__(256) ln_kernel(const float* x, const float* res, float alpha, const float* g, const float* b, float* out) {
    __shared__ float red[4];
    const size_t row = blockIdx.x;
    const int c = threadIdx.x * 4;
    float4 v = *(const float4*)(x + row * D + c);
    if (res) { const float4 r = *(const float4*)(res + row * D + c); v.x += alpha * r.x; v.y += alpha * r.y; v.z += alpha * r.z; v.w += alpha * r.w; }
    const float mean = block_sum(v.x + v.y + v.z + v.w, red) * (1.f / D);
    v.x -= mean; v.y -= mean; v.z -= mean; v.w -= mean;
    const float var = block_sum(v.x * v.x + v.y * v.y + v.z * v.z + v.w * v.w, red) * (1.f / D);
    const float rstd = 1.0f / sqrtf(var + LN_EPS);
    const float4 gg = *(const float4*)(g + c), bb = *(const float4*)(b + c);
    float4 o = {v.x * rstd * gg.x + bb.x, v.y * rstd * gg.y + bb.y, v.z * rstd * gg.z + bb.z, v.w * rstd * gg.w + bb.w};
    *(float4*)(out + row * D + c) = o;
}

__global__ void __launch_bounds__(256) rms_kernel(const float* in, int ldi, int ic, const float* g, float* out, int ldo, int oc, int w) {
    __shared__ float red[4];
    const size_t row = blockIdx.x;
    float ss = 0.f;
    for (int i = threadIdx.x; i < w; i += 256) { const float v = in[row * ldi + ic + i]; ss += v * v; }
    const float rstd = 1.0f / sqrtf(block_sum(ss, red) / (float)w + RMS_EPS);
    for (int i = threadIdx.x; i < w; i += 256) out[row * ldo + oc + i] = in[row * ldi + ic + i] * rstd * g[i];
}

__global__ void rope_kernel(float* buf, int ld, int c0, int nheads, int hw, int rot, const int* pos) {
    const int half = rot / 2;
    const int idx = blockIdx.x * blockDim.x + threadIdx.x;
    const int total = S * nheads * half;
    if (idx >= total) return;
    const int i = idx % half, hh = (idx / half) % nheads, s = idx / (half * nheads);
    const float inv_freq = exp2f(-(float)i * (2.0f / (float)rot) * LOG2_THETA);
    const float ang = (float)pos[s] * inv_freq;
    float sn, cs; sincosf(ang, &sn, &cs);
    float* p = buf + (size_t)s * ld + c0 + hh * hw;
    const float x1 = p[i], x2 = p[i + half];
    p[i] = x1 * cs - x2 * sn; p[i + half] = x2 * cs + x1 * sn;
}

__global__ void __launch_bounds__(64) swa_kernel(const float* __restrict__ h, float* __restrict__ o) {
    const int s = blockIdx.x * 64 + threadIdx.x, hh = blockIdx.y;
    const float* qp = h + (size_t)s * INW + hh * 64;
    float q[64];
#pragma unroll
    for (int i = 0; i < 64; i += 4) { const float4 v = *(const float4*)(qp + i); q[i] = v.x; q[i + 1] = v.y; q[i + 2] = v.z; q[i + 3] = v.w; }
    float outv[64];
#pragma unroll
    for (int i = 0; i < 64; ++i) outv[i] = 0.f;
    float lse_run = -INFINITY, wsum = 0.f;
    for (int p = 0; p < 3; ++p) {
        const int d = (p == 0) ? 1 : (p == 1) ? 4 : 16;
        const int L = S / d, n = s / d;
        float m = -INFINITY, den = 0.f;
        float acc[64];
#pragma unroll
        for (int i = 0; i < 64; ++i) acc[i] = 0.f;
        for (int j = -64; j <= 64; ++j) {
            const int kn = n + j;
            if (kn < 0 || kn >= L) continue;
            const int kpos = s + j * d;
            const float* kp = h + (size_t)kpos * INW + 512 + hh * 64;
            const float* vp = h + (size_t)kpos * INW + 1024 + hh * 64;
            float sc = 0.f;
#pragma unroll
            for (int i = 0; i < 64; i += 4) { const float4 kv = *(const float4*)(kp + i); sc = fmaf(q[i], kv.x, sc); sc = fmaf(q[i + 1], kv.y, sc); sc = fmaf(q[i + 2], kv.z, sc); sc = fmaf(q[i + 3], kv.w, sc); }
            sc *= 0.125f;
            const float mn = fmaxf(m, sc);
            const float f = __expf(m - mn), pe = __expf(sc - mn);
            den = den * f + pe;
#pragma unroll
            for (int i = 0; i < 64; i += 4) { const float4 vv = *(const float4*)(vp + i);
                acc[i] = acc[i] * f + pe * vv.x; acc[i + 1] = acc[i + 1] * f + pe * vv.y; acc[i + 2] = acc[i + 2] * f + pe * vv.z; acc[i + 3] = acc[i + 3] * f + pe * vv.w; }
            m = mn;
        }
        const float lse = m + __logf(den);
        const float ln = fmaxf(lse_run, lse);
        const float f_old = __expf(lse_run - ln), f_new = __expf(lse - ln);
        wsum = wsum * f_old + f_new;
        const float sc_new = f_new / den;
#pragma unroll
        for (int i = 0; i < 64; ++i) outv[i] = outv[i] * f_old + acc[i] * sc_new;
        lse_run = ln;
    }
    const float inv = 1.f / wsum;
    float* op = o + (size_t)s * 1024 + hh * 64;
#pragma unroll
    for (int i = 0; i < 64; i += 4) { float4 v = {outv[i] * inv, outv[i + 1] * inv, outv[i + 2] * inv, outv[i + 3] * inv}; *(float4*)(op + i) = v; }
}

__global__ void __launch_bounds__(256) mla_kernel(const float* __restrict__ qb, const float* __restrict__ kv, const float* __restrict__ hbuf, float* __restrict__ o) {
    const int sub = threadIdx.x & 3, s = blockIdx.x * 64 + (threadIdx.x >> 2), hh = blockIdx.y;
    float q[48];
    {
        const float* qp = qb + (size_t)s * 768 + hh * 192;
#pragma unroll
        for (int i = 0; i < 32; ++i) q[i] = qp[sub * 32 + i];
#pragma unroll
        for (int i = 0; i < 16; ++i) q[32 + i] = qp[128 + sub * 16 + i];
    }
    const float scale = 0.07216878364870322f;
    float m = -INFINITY, den = 0.f, acc[32];
#pragma unroll
    for (int i = 0; i < 32; ++i) acc[i] = 0.f;
    for (int j = 0; j < S; ++j) {
        const float* kp = kv + (size_t)j * 1024 + hh * 256 + sub * 32;
        const float* pp = hbuf + (size_t)j * INW + 1920 + sub * 16;
        const float* vp = kv + (size_t)j * 1024 + hh * 256 + 128 + sub * 32;
        float sc = 0.f;
#pragma unroll
        for (int i = 0; i < 32; i += 4) { const float4 k4 = *(const float4*)(kp + i); sc = fmaf(q[i], k4.x, sc); sc = fmaf(q[i + 1], k4.y, sc); sc = fmaf(q[i + 2], k4.z, sc); sc = fmaf(q[i + 3], k4.w, sc); }
#pragma unroll
        for (int i = 0; i < 16; i += 4) { const float4 k4 = *(const float4*)(pp + i); sc = fmaf(q[32 + i], k4.x, sc); sc = fmaf(q[33 + i], k4.y, sc); sc = fmaf(q[34 + i], k4.z, sc); sc = fmaf(q[35 + i], k4.w, sc); }
        sc += __shfl_xor(sc, 1); sc += __shfl_xor(sc, 2);
        sc *= scale;
        const float mn = fmaxf(m, sc);
        const float f = __expf(m - mn), pe = __expf(sc - mn);
        den = den * f + pe;
#pragma unroll
        for (int i = 0; i < 32; i += 4) { const float4 v4 = *(const float4*)(vp + i);
            acc[i] = acc[i] * f + pe * v4.x; acc[i + 1] = acc[i + 1] * f + pe * v4.y; acc[i + 2] = acc[i + 2] * f + pe * v4.z; acc[i + 3] = acc[i + 3] * f + pe * v4.w; }
        m = mn;
    }
    const float inv = 1.f / den;
    float* op = o + (size_t)s * 1024 + 512 + hh * 128 + sub * 32;
#pragma unroll
    for (int i = 0; i < 32; ++i) op[i] = acc[i] * inv;
}

__global__ void conv_act_kernel(const float* __restrict__ u, const float* __restrict__ cw, const float* __restrict__ cb, float* __restrict__ act) {
    const int c = blockIdx.x * blockDim.x + threadIdx.x; const int s = blockIdx.y;
    if (c >= FF) return;
    float g = cb[c], v = cb[FF + c];
#pragma unroll
    for (int t = 0; t < 3; ++t) {
        const int ss = s + t - 1;
        if (ss < 0 || ss >= S) continue;
        g = fmaf(u[(size_t)ss * FF2 + c], cw[t * FF2 + c], g);
        v = fmaf(u[(size_t)ss * FF2 + FF + c], cw[t * FF2 + FF + c], v);
    }
    const float sg = g / (1.f + __expf(-g));
    act[(size_t)s * FF + c] = sg * v;
}

static void gemm(const float* A, int lda, const float* Bm, int ldb, float* C, int ldc, int Mr, int N, int K, hipStream_t st) {
    hipLaunchKernelGGL(gemm_f32, dim3(N / 64, Mr / 64), dim3(256), 0, st, A, lda, Bm, ldb, C, ldc, K);
}

extern "C" void kernel_launch(void* const* d_in, const int* in_sizes, int n_in, void* d_out, int out_size, void* d_ws, size_t ws_size, hipStream_t stream) {
    const float* x = (const float*)d_in[0]; const int* positions = (const int*)d_in[1];
    const float* ln_emb_g = (const float*)d_in[2]; const float* ln_emb_b = (const float*)d_in[3];
    const float* w_in = (const float*)d_in[4]; const float* q_norm_g = (const float*)d_in[5]; const float* w_uq = (const float*)d_in[6];
    const float* kv_norm_g = (const float*)d_in[7]; const float* w_ukv = (const float*)d_in[8]; const float* out_norm_g = (const float*)d_in[9];
    const float* w_o = (const float*)d_in[10]; const float* ln1_g = (const float*)d_in[11]; const float* ln1_b = (const float*)d_in[12];
    const float* w_up = (const float*)d_in[13]; const float* conv_w = (const float*)d_in[14]; const float* conv_b = (const float*)d_in[15];
    const float* w_down = (const float*)d_in[16]; const float* ln2_g = (const float*)d_in[17]; const float* ln2_b = (const float*)d_in[18];
    float* out = (float*)d_out;
    float* ws = (float*)d_ws;
    float* x0 = ws;
    float* hb = x0 + (size_t)S * D;
    float* cqn = hb + (size_t)S * INW;
    float* ckvn = cqn + (size_t)S * 256;
    float* qb = ckvn + (size_t)S * 128;
    float* kvb = qb + (size_t)S * 768;
    float* ob = kvb + (size_t)S * 1024;
    float* on = ob + (size_t)S * 1024;
    float* tb = on + (size_t)S * 1024;
    float* ub = tb + (size_t)S * 1024;
    float* actb = ub + (size_t)S * FF2;
    for (int b = 0; b < NB; ++b) {
        const float* xb = x + (size_t)b * S * D; const int* pb = positions + (size_t)b * S; float* outb = out + (size_t)b * S * D;
        hipLaunchKernelGGL(ln_kernel, dim3(S), dim3(256), 0, stream, xb, (const float*)nullptr, 0.f, ln_emb_g, ln_emb_b, x0);
        gemm(x0, D, w_in, INW, hb, INW, S, INW, D, stream);
        hipLaunchKernelGGL(rope_kernel, dim3((S * 8 * 8 + 255) / 256), dim3(256), 0, stream, hb, INW, 0, 8, 64, 16, pb);
        hipLaunchKernelGGL(rope_kernel, dim3((S * 8 * 8 + 255) / 256), dim3(256), 0, stream, hb, INW, 512, 8, 64, 16, pb);
        hipLaunchKernelGGL(rope_kernel, dim3((S * 1 * 32 + 255) / 256), dim3(256), 0, stream, hb, INW, 1920, 1, 64, 64, pb);
        hipLaunchKernelGGL(swa_kernel, dim3(S / 64, 8), dim3(64), 0, stream, hb, ob);
        hipLaunchKernelGGL(rms_kernel, dim3(S), dim3(256), 0, stream, hb, INW, 1536, q_norm_g, cqn, 256, 0, 256);
        hipLaunchKernelGGL(rms_kernel, dim3(S), dim3(256), 0, stream, hb, INW, 1792, kv_norm_g, ckvn, 128, 0, 128);
        gemm(cqn, 256, w_uq, 768, qb, 768, S, 768, 256, stream);
        gemm(ckvn, 128, w_ukv, 1024, kvb, 1024, S, 1024, 128, stream);
        for (int hh = 0; hh < 4; ++hh)
            hipLaunchKernelGGL(rope_kernel, dim3((S * 1 * 32 + 255) / 256), dim3(256), 0, stream, qb, 768, hh * 192 + 128, 1, 64, 64, pb);
        hipLaunchKernelGGL(mla_kernel, dim3(S / 64, 4), dim3(256), 0, stream, qb, kvb, hb, ob);
        hipLaunchKernelGGL(rms_kernel, dim3(S), dim3(256), 0, stream, ob, 1024, 0, out_norm_g, on, 1024, 0, 512);
        hipLaunchKernelGGL(rms_kernel, dim3(S), dim3(256), 0, stream, ob, 1024, 512, out_norm_g + 512, on, 1024, 512, 512);
        gemm(on, 1024, w_o, D, tb, D, S, D, 1024, stream);
        hipLaunchKernelGGL(ln_kernel, dim3(S), dim3(256), 0, stream, tb, x0, ALPHA, ln1_g, ln1_b, outb);
        gemm(outb, D, w_up, FF2, ub, FF2, S, FF2, D, stream);
        hipLaunchKernelGGL(conv_act_kernel, dim3((FF + 255) / 256, S), dim3(256), 0, stream, ub, conv_w, conv_b, actb);
        gemm(actb, FF, w_down, D, tb, D, S, D, FF, stream);
        hipLaunchKernelGGL(ln_kernel, dim3(S), dim3(256), 0, stream, tb, outb, ALPHA, ln2_g, ln2_b, outb);
    }
}
```

```cpp
#include <hip/hip_runtime.h>
#include <cstdio>
#include <cstdint>

constexpr int NB = 8, S = 4096, D = 1024, M = NB * S;
constexpr int INW = 1984, INWP = 2048, FF = 2816, FF2 = 2 * FF;
constexpr float LN_EPS = 1e-5f, RMS_EPS = 1e-6f;
constexpr float ALPHA = 1.189207115002721f;
constexpr float LOG2_THETA = 18.931568569324174f;
constexpr float LOG2E = 1.4426950408889634f;
constexpr float QSC_A = 0.125f * LOG2E;
constexpr float QSC_B = 0.07216878364870322f * LOG2E;
namespace pg8 {
#define PG8_LAS __attribute__((address_space(3)))
typedef unsigned short bf16_t;
typedef short bf16x8 __attribute__((ext_vector_type(8)));
typedef float f32x4 __attribute__((ext_vector_type(4)));
typedef unsigned u32x4 __attribute__((ext_vector_type(4)));
constexpr int BM = 256, BK = 64, HALF = 128, HTB = HALF * BK * 2  , STAGE_BYTES = 8 * HTB, NXCD = 8, WGM = 8;

__host__ __device__ __forceinline__ int lds_byte(int r, int c) { const int st = (r >> 4) * 2 + (c >> 5), rr = r & 15, cc = c & 31, ob = rr * 64 + cc * 2; return st * 1024 + (ob ^ (((ob >> 9) & 1) << 5)); }
__host__ __device__ __forceinline__ void stage_rc(int b, int& R, int& C) { const int st = b / 1024, sb = b % 1024, swz = sb ^ (((sb >> 9) & 1) << 5); R = (st >> 1) * 16 + swz / 64; C = (st & 1) * 32 + (swz % 64) / 2; }
__host__ __device__ __forceinline__ int perm32(int rho) { const int n = rho >> 4, i = rho & 15; return 8 * (i >> 2) + 4 * n + (i & 3); }

struct Unit { int pm, pn; };
struct Gemm { const bf16_t* A; const bf16_t* Bt; int M, N, K; };

struct StaticOrder {
    int nM, nN, nwg, G, c;
    __host__ __device__ void init(int M, int N, int G_, int c_) { nM = M / BM; nN = N / BM; nwg = nM * nN; G = G_; c = c_; }
    __host__ __device__ bool next(int i, Unit& u) const {
        const long L = (long)i * G + c; if (L >= nwg) return false;
        int wgid = (int)L; { const int q = nwg / NXCD, r = nwg % NXCD, xcd = wgid % NXCD, off = wgid / NXCD; wgid = (xcd < r ? xcd * (q + 1) : r * (q + 1) + (xcd - r) * q) + off; }
        const int nig = WGM * nN, gid = wgid / nig, fm = gid * WGM, gsz = (nM - fm) < WGM ? (nM - fm) : WGM;
        u.pm = fm + ((wgid % nig) % gsz); u.pn = (wgid % nig) / gsz; return true;
    }
    __device__ __forceinline__ void a_ready(const Unit&) const {}
    __device__ __forceinline__ void done(const Unit&) const {}
};

}
namespace pg8 {
__device__ __forceinline__ unsigned cvt_pk_bf16(float lo, float hi) { unsigned r; asm volatile("v_cvt_pk_bf16_f32 %0, %1, %2" : "=v"(r) : "v"(lo), "v"(hi)); return r; }
__device__ __forceinline__ u32x4 pack8(f32x4 v0, f32x4 v1) { u32x4 w; w.x = cvt_pk_bf16(v0[0], v0[1]); w.y = cvt_pk_bf16(v0[2], v0[3]); w.z = cvt_pk_bf16(v1[0], v1[1]); w.w = cvt_pk_bf16(v1[2], v1[3]); return w; }
__device__ __forceinline__ float sumsq4(f32x4 v) { return (v[0] * v[0] + v[1] * v[1]) + (v[2] * v[2] + v[3] * v[3]); }
struct EpiIn {
    static constexpr bool PERM = true, AFTER_DRAIN = false, HAS_MID = false;
    bf16_t *QA, *KA, *VA, *CQ, *CKV, *KPE; float *ssq_q, *ssq_kv; const float *ropeA, *ropeB;
    __device__ __forceinline__ void operator()(const f32x4 (&acc)[2][2][4][2], const Unit& u, int wr, int wc, int fr, int fq) const {
        const int pn = u.pn, rowb = u.pm * BM + wr * 64 + fr, cg = wc * 32 + 8 * fq;
        if (pn < 4) {
            bf16_t* base = (pn < 2 ? QA : KA) + (pn & 1) * 256 + cg; const float sc = pn < 2 ? QSC_A : 1.f;
            const bool rot = ((wc & 1) == 0) && fq < 2;
#pragma unroll
            for (int ai = 0; ai < 2; ++ai)
#pragma unroll
                for (int m = 0; m < 4; ++m) { const int row = rowb + ai * HALF + m * 16;
                    f32x4 cs = {1.f, 1.f, 1.f, 1.f}, sn = {0.f, 0.f, 0.f, 0.f};
                    if (rot) { cs = *(const f32x4*)(ropeA + (size_t)row * 16 + 4 * fq); sn = *(const f32x4*)(ropeA + (size_t)row * 16 + 8 + 4 * fq); }
#pragma unroll
                    for (int bj = 0; bj < 2; ++bj) { const f32x4 x1 = acc[ai][bj][m][0], x2 = acc[ai][bj][m][1];
                        const f32x4 v0 = (x1 * cs - x2 * sn) * sc, v1 = (x2 * cs + x1 * sn) * sc;
                        *(u32x4*)(base + (size_t)row * 512 + bj * HALF) = pack8(v0, v1); } }
        } else if (pn < 6) {
            bf16_t* base = VA + (pn - 4) * 256 + cg;
#pragma unroll
            for (int ai = 0; ai < 2; ++ai)
#pragma unroll
                for (int m = 0; m < 4; ++m) { const int row = rowb + ai * HALF + m * 16;
#pragma unroll
                    for (int bj = 0; bj < 2; ++bj) *(u32x4*)(base + (size_t)row * 512 + bj * HALF) = pack8(acc[ai][bj][m][0], acc[ai][bj][m][1]); }
        } else if (pn == 6) {
#pragma unroll
            for (int ai = 0; ai < 2; ++ai)
#pragma unroll
                for (int m = 0; m < 4; ++m) { const int row = rowb + ai * HALF + m * 16; float s = 0.f;
#pragma unroll
                    for (int bj = 0; bj < 2; ++bj) { s += sumsq4(acc[ai][bj][m][0]) + sumsq4(acc[ai][bj][m][1]);
                        *(u32x4*)(CQ + (size_t)row * 256 + bj * HALF + cg) = pack8(acc[ai][bj][m][0], acc[ai][bj][m][1]); }
                    s += __shfl_xor(s, 16); s += __shfl_xor(s, 32);
                    if (fq == 0) ssq_q[(size_t)row * 4 + wc] = s; }
        } else {
#pragma unroll
            for (int ai = 0; ai < 2; ++ai)
#pragma unroll
                for (int m = 0; m < 4; ++m) { const int row = rowb + ai * HALF + m * 16;
                    float s = sumsq4(acc[ai][0][m][0]) + sumsq4(acc[ai][0][m][1]);
                    *(u32x4*)(CKV + (size_t)row * 128 + cg) = pack8(acc[ai][0][m][0], acc[ai][0][m][1]);
                    s += __shfl_xor(s, 16); s += __shfl_xor(s, 32);
                    if (fq == 0) ssq_kv[(size_t)row * 4 + wc] = s;
                    if (wc < 2) { const int a4 = 4 * (4 * wc + fq);
                        const f32x4 cs = *(const f32x4*)(ropeB + (size_t)row * 64 + a4), sn = *(const f32x4*)(ropeB + (size_t)row * 64 + 32 + a4);
                        const f32x4 x1 = acc[ai][1][m][0], x2 = acc[ai][1][m][1];
                        *(u32x4*)(KPE + (size_t)row * 64 + cg) = pack8(x1 * cs - x2 * sn, x2 * cs + x1 * sn); } }
        }
    }
};
struct EpiQb {
    static constexpr bool PERM = true, AFTER_DRAIN = false, HAS_MID = false;
    bf16_t* QB; const float* ssq_q; const float* ropeB;
    __device__ __forceinline__ void operator()(const f32x4 (&acc)[2][2][4][2], const Unit& u, int wr, int wc, int fr, int fq) const {
        const int rowb = u.pm * BM + wr * 64 + fr, cg = wc * 32 + 8 * fq;
#pragma unroll
        for (int ai = 0; ai < 2; ++ai)
#pragma unroll
            for (int m = 0; m < 4; ++m) { const int row = rowb + ai * HALF + m * 16;
                const f32x4 s4 = *(const f32x4*)(ssq_q + (size_t)row * 4);
                const float rstd = 1.0f / sqrtf(((s4[0] + s4[1]) + (s4[2] + s4[3])) * (1.f / 256.f) + RMS_EPS);
#pragma unroll
                for (int bj = 0; bj < 2; ++bj) { const int gc = u.pn * BM + bj * HALF + cg, w = gc % 192;
                    f32x4 x1 = acc[ai][bj][m][0] * rstd, x2 = acc[ai][bj][m][1] * rstd;
                    if (w >= 128) { const int a4 = (w - 128) >> 1;
                        const f32x4 cs = *(const f32x4*)(ropeB + (size_t)row * 64 + a4), sn = *(const f32x4*)(ropeB + (size_t)row * 64 + 32 + a4);
                        const f32x4 t1 = x1 * cs - x2 * sn, t2 = x2 * cs + x1 * sn; x1 = t1; x2 = t2; }
                    *(u32x4*)(QB + (size_t)row * 768 + gc) = pack8(x1, x2); } }
    }
};
struct EpiKv {
    static constexpr bool PERM = true, AFTER_DRAIN = false, HAS_MID = false;
    bf16_t* KVB; const float* ssq_kv;
    __device__ __forceinline__ void operator()(const f32x4 (&acc)[2][2][4][2], const Unit& u, int wr, int wc, int fr, int fq) const {
        const int rowb = u.pm * BM + wr * 64 + fr, cg = wc * 32 + 8 * fq;
#pragma unroll
        for (int ai = 0; ai < 2; ++ai)
#pragma unroll
            for (int m = 0; m < 4; ++m) { const int row = rowb + ai * HALF + m * 16;
                const f32x4 s4 = *(const f32x4*)(ssq_kv + (size_t)row * 4);
                const float rstd = 1.0f / sqrtf(((s4[0] + s4[1]) + (s4[2] + s4[3])) * (1.f / 128.f) + RMS_EPS);
#pragma unroll
                for (int bj = 0; bj < 2; ++bj) *(u32x4*)(KVB + (size_t)row * 1024 + u.pn * BM + bj * HALF + cg) = pack8(acc[ai][bj][m][0] * rstd, acc[ai][bj][m][1] * rstd); }
    }
};
}
namespace pg8 {
template <class Epi, class Sched, bool ALIGN_EPI = false, bool SP2 = false>
__device__ __forceinline__ void gemm_phase(PG8_LAS unsigned char* lds, const Gemm g, const Sched& S, const Epi& E) {
    int tid_ = threadIdx.x; asm volatile("" : "+v"(tid_));
    const int tid = tid_, wid = __builtin_amdgcn_readfirstlane(tid >> 6), lane = tid & 63, wr = wid >> 2, wc = wid & 3, fr = lane & 15, fq = lane >> 4;
    const int K = g.K, nt = K / BK;
    unsigned voffA[2], voffB[2];
#pragma unroll
    for (int i = 0; i < 2; ++i) { int R, C; stage_rc(tid * 16 + i * 8192, R, C); const int Rb = Epi::PERM ? ((R & ~31) + perm32(R & 31)) : R;
        voffA[i] = (unsigned)(R * K + C) * 2u; voffB[i] = (unsigned)(Rb * K + C) * 2u; }
    const size_t kstep = (size_t)(BK * 2);
    const size_t hstep = (size_t)HALF * K * 2;
    const size_t tstep = 2 * hstep;
    const unsigned ldsw = (unsigned)wid * 1024u;
    const int aoff = lds_byte(wr * 64 + fr, fq * 8), boff = lds_byte(wc * 32 + fr, fq * 8);
#define PG8_SA(b, h) (((b) * 2 + (h)) * HTB)
#define PG8_SB(b, h) ((4 + (b) * 2 + (h)) * HTB)
#define PG8_STAGE(bufoff, gbase, voff) do { _Pragma("unroll") for (int _i = 0; _i < 2; ++_i) \
        __builtin_amdgcn_global_load_lds((const unsigned*)((const char*)(gbase) + (voff)[_i]), (PG8_LAS unsigned*)(lds + (bufoff) + ldsw + _i * 8192), 16, 0, 0); } while (0)
#define PG8_LDA(dst, b, h) do { _Pragma("unroll") for (int m = 0; m < 4; ++m) _Pragma("unroll") for (int k = 0; k < 2; ++k) dst[m][k] = *(const PG8_LAS bf16x8*)(lds + PG8_SA(b, h) + aoff + m * 2048 + k * 1024); } while (0)
#define PG8_LDB(dst, b, h) do { _Pragma("unroll") for (int n = 0; n < 2; ++n) _Pragma("unroll") for (int k = 0; k < 2; ++k) dst[n][k] = *(const PG8_LAS bf16x8*)(lds + PG8_SB(b, h) + boff + n * 2048 + k * 1024); } while (0)
#define PG8_MMA(ai, bj, At, Bt) do { __builtin_amdgcn_s_setprio(1); _Pragma("unroll") for (int m = 0; m < 4; ++m) _Pragma("unroll") for (int n = 0; n < 2; ++n) _Pragma("unroll") for (int k = 0; k < 2; ++k) \
        acc[ai][bj][m][n] = __builtin_amdgcn_mfma_f32_16x16x32_bf16(Bt[n][k], At[m][k], acc[ai][bj][m][n], 0, 0, 0); __builtin_amdgcn_s_setprio(0); } while (0)
#define PG8_WAIT_V(n) asm volatile("s_waitcnt vmcnt(" #n ")" ::: "memory")
#define PG8_WAIT_L(n) asm volatile("s_waitcnt lgkmcnt(" #n ")" ::: "memory")
#define PG8_BAR __builtin_amdgcn_s_barrier()
#define PG8_SCHED __builtin_amdgcn_sched_barrier(0)
    Unit cur, nxt; int ui = 0;
    if (!S.next(0, cur)) return;
    f32x4 acc[2][2][4][2];
#pragma unroll
    for (int a = 0; a < 2; ++a)
#pragma unroll
        for (int b = 0; b < 2; ++b)
#pragma unroll
            for (int m = 0; m < 4; ++m)
#pragma unroll
                for (int n = 0; n < 2; ++n) acc[a][b][m][n] = (f32x4){0.f, 0.f, 0.f, 0.f};
    bf16x8 At[4][2], B0[2][2], B1[2][2];
    const char* cA = (const char*)g.A + (size_t)cur.pm * tstep; const char* cB = (const char*)g.Bt + (size_t)cur.pn * tstep;
    S.a_ready(cur);
    if constexpr (SP2) {
        PG8_STAGE(PG8_SB(0, 0), cB, voffB); PG8_STAGE(PG8_SB(0, 1), cB + hstep, voffB); PG8_STAGE(PG8_SA(0, 0), cA, voffA); PG8_STAGE(PG8_SA(0, 1), cA + hstep, voffA);
        if (wr == 1) PG8_BAR;
        PG8_WAIT_V(2); PG8_BAR;
        PG8_STAGE(PG8_SB(1, 0), cB + kstep, voffB); PG8_STAGE(PG8_SA(1, 0), cA + kstep, voffA); PG8_STAGE(PG8_SB(1, 1), cB + hstep + kstep, voffB);
        PG8_WAIT_V(6); PG8_BAR;
    } else {
        PG8_STAGE(PG8_SB(0, 0), cB, voffB); PG8_STAGE(PG8_SA(0, 0), cA, voffA); PG8_STAGE(PG8_SB(0, 1), cB + hstep, voffB); PG8_STAGE(PG8_SA(0, 1), cA + hstep, voffA);
        if (wr == 1) PG8_BAR;
        PG8_WAIT_V(4); PG8_BAR;
        PG8_STAGE(PG8_SB(1, 0), cB + kstep, voffB); PG8_STAGE(PG8_SA(1, 0), cA + kstep, voffA); PG8_STAGE(PG8_SB(1, 1), cB + hstep + kstep, voffB);
        PG8_WAIT_V(6); PG8_BAR;
    }
    for (;;) {
        const bool has_next = S.next(ui + 1, nxt);
        const char* nA = has_next ? (const char*)g.A + (size_t)nxt.pm * tstep : cA; const char* nB = has_next ? (const char*)g.Bt + (size_t)nxt.pn * tstep : cB;
        for (int t = 0; t < nt; t += 2) {
            if constexpr (Epi::HAS_MID) { if (t == Epi::MID_T) E.mid(acc, cur, wr, wc, fr, fq); }
            const bool last = (t == nt - 2);
            const char* a1 = cA + (size_t)(t + 1) * kstep;
            const char* a2 = last ? nA : cA + (size_t)(t + 2) * kstep; const char* b2 = last ? nB : cB + (size_t)(t + 2) * kstep;
            const char* a3 = a2 + kstep; const char* b3 = b2 + kstep;
            if (last && has_next) S.a_ready(nxt);
            if constexpr (SP2) {
            PG8_LDB(B0, 0, 0); PG8_LDB(B1, 0, 1); PG8_SCHED; PG8_LDA(At, 0, 0); PG8_STAGE(PG8_SA(1, 1), a1 + hstep, voffA);
            PG8_WAIT_V(8); PG8_WAIT_L(0); PG8_BAR; PG8_MMA(0, 0, At, B0); PG8_MMA(0, 1, At, B1); PG8_BAR; PG8_SCHED;
            PG8_LDA(At, 0, 1); PG8_STAGE(PG8_SB(0, 0), b2, voffB); PG8_STAGE(PG8_SB(0, 1), b2 + hstep, voffB); PG8_STAGE(PG8_SA(0, 0), a2, voffA);
            PG8_WAIT_V(8); PG8_WAIT_L(0); PG8_BAR; PG8_MMA(1, 0, At, B0); PG8_MMA(1, 1, At, B1); PG8_BAR; PG8_SCHED;
            PG8_LDB(B0, 1, 0); PG8_LDB(B1, 1, 1); PG8_SCHED; PG8_LDA(At, 1, 0); PG8_STAGE(PG8_SA(0, 1), a2 + hstep, voffA);
            PG8_WAIT_V(8); PG8_WAIT_L(0); PG8_BAR; PG8_MMA(0, 0, At, B0); PG8_MMA(0, 1, At, B1); PG8_BAR; PG8_SCHED;
            PG8_LDA(At, 1, 1); PG8_STAGE(PG8_SB(1, 0), b3, voffB); PG8_STAGE(PG8_SB(1, 1), b3 + hstep, voffB); PG8_STAGE(PG8_SA(1, 0), a3, voffA);
            PG8_WAIT_V(8); PG8_WAIT_L(0); PG8_BAR; PG8_MMA(1, 0, At, B0); PG8_MMA(1, 1, At, B1); PG8_BAR; PG8_SCHED;
            } else {
            PG8_LDB(B0, 0, 0); PG8_SCHED; PG8_LDA(At, 0, 0); PG8_STAGE(PG8_SA(1, 1), a1 + hstep, voffA);
            PG8_WAIT_L(8); PG8_BAR; PG8_WAIT_L(0); PG8_MMA(0, 0, At, B0); PG8_BAR; PG8_SCHED;
            PG8_LDB(B1, 0, 1); PG8_STAGE(PG8_SB(0, 0), b2, voffB);
            PG8_BAR; PG8_WAIT_L(0); PG8_MMA(0, 1, At, B1); PG8_BAR;
            PG8_LDA(At, 0, 1); PG8_STAGE(PG8_SA(0, 0), a2, voffA);
            PG8_BAR; PG8_WAIT_L(0); PG8_MMA(1, 0, At, B0); PG8_BAR; PG8_SCHED;
            PG8_STAGE(PG8_SB(0, 1), b2 + hstep, voffB);
            PG8_WAIT_V(6); PG8_BAR; PG8_MMA(1, 1, At, B1); PG8_BAR;
            PG8_LDB(B0, 1, 0); PG8_SCHED; PG8_LDA(At, 1, 0); PG8_STAGE(PG8_SA(0, 1), a2 + hstep, voffA);
            PG8_WAIT_L(8); PG8_BAR; PG8_WAIT_L(0); PG8_MMA(0, 0, At, B0); PG8_BAR; PG8_SCHED;
            PG8_LDB(B1, 1, 1); PG8_STAGE(PG8_SB(1, 0), b3, voffB);
            PG8_BAR; PG8_WAIT_L(0); PG8_MMA(0, 1, At, B1); PG8_BAR;
            PG8_LDA(At, 1, 1); PG8_STAGE(PG8_SA(1, 0), a3, voffA);
            PG8_BAR; PG8_WAIT_L(0); PG8_MMA(1, 0, At, B0); PG8_BAR; PG8_SCHED;
            PG8_STAGE(PG8_SB(1, 1), b3 + hstep, voffB);
            PG8_WAIT_V(6); PG8_BAR; PG8_MMA(1, 1, At, B1); PG8_BAR;
            }
        }
        if constexpr (ALIGN_EPI) { if (wr == 0) PG8_BAR; }
        if constexpr (!Epi::AFTER_DRAIN) { E(acc, cur, wr, wc, fr, fq); S.done(cur); }
        if (!has_next) break;
#pragma unroll
        for (int a = 0; a < 2; ++a)
#pragma unroll
            for (int b = 0; b < 2; ++b)
#pragma unroll
                for (int m = 0; m < 4; ++m)
#pragma unroll
                    for (int n = 0; n < 2; ++n) acc[a][b][m][n] = (f32x4){0.f, 0.f, 0.f, 0.f};
        cur = nxt; cA = nA; cB = nB; ++ui;
        if constexpr (ALIGN_EPI) { if (wr == 1) PG8_BAR; }
    }
    PG8_WAIT_V(0);
    if constexpr (!ALIGN_EPI) { if (wr == 0) PG8_BAR; }
    PG8_BAR;
    if constexpr (Epi::AFTER_DRAIN) { E.fused(acc, cur, wr, wc, fr, fq, lds, wid, lane); S.done(cur); }
#undef PG8_SA
#undef PG8_SB
#undef PG8_STAGE
#undef PG8_LDA
#undef PG8_LDB
#undef PG8_MMA
#undef PG8_WAIT_V
#undef PG8_WAIT_L
#undef PG8_BAR
#undef PG8_SCHED
}
}
#define GAS __attribute__((address_space(1)))
#define LAS __attribute__((address_space(3)))
typedef unsigned short bf16;
typedef unsigned v4u __attribute__((ext_vector_type(4)));
typedef float f32x4 __attribute__((ext_vector_type(4)));
typedef short bf16x8 __attribute__((ext_vector_type(8)));
typedef GAS unsigned gu32;
typedef GAS unsigned long long gu64;
#define RLX_AGENT __ATOMIC_RELAXED, __HIP_MEMORY_SCOPE_AGENT
#define LDS_WAIT() asm volatile("s_waitcnt lgkmcnt(0)" ::: "memory")
#define VM_WAIT() asm volatile("s_waitcnt vmcnt(0)" ::: "memory")
__device__ __forceinline__ unsigned long long rt() { return __builtin_amdgcn_s_memrealtime(); }
__device__ __forceinline__ unsigned f2bf(float f) { unsigned u = __builtin_bit_cast(unsigned, f); return (u + 0x7fffu + ((u >> 16) & 1u)) >> 16; }
__device__ __forceinline__ unsigned pk2(float lo, float hi) { return f2bf(lo) | (f2bf(hi) << 16); }

#define XB_TMO      128
#define XB_XCNT(j)  (256  + 64 * (j))
#define XB_XSUB(j)  (1280 + 64 * (j))
#define XB_XGEN(j)  (2304 + 64 * (j))
#define XB_TOP      3328
#define XB_TOPGEN   3392
#define XCD_BAR_WORDS 3456
#define XB_SPIN_CAP (1u << 18)

__device__ __forceinline__ unsigned xb_ld(unsigned* p)              { return __hip_atomic_load(p, __ATOMIC_RELAXED, __HIP_MEMORY_SCOPE_AGENT); }
__device__ __forceinline__ unsigned xb_add(unsigned* p, unsigned v) { return __hip_atomic_fetch_add(p, v, __ATOMIC_RELAXED, __HIP_MEMORY_SCOPE_AGENT); }
__device__ __forceinline__ unsigned xb_xcc_id() { return (unsigned)__builtin_amdgcn_s_getreg((3 << 11) | 20) & 0xFu; }
#define XB_SPIN(cond, bar) do { unsigned _sp = 0; while (cond) { __builtin_amdgcn_s_sleep(1); \
    if ((++_sp & 255u) == 0u) { if (xb_ld(&(bar)[XB_TMO])) break; if (_sp > XB_SPIN_CAP) { atomicAdd(&(bar)[XB_TMO], 1u); break; } } } } while (0)

struct XcdBarrier {
    unsigned* bar; unsigned x;
    volatile LAS unsigned* st;
};

__device__ __forceinline__ XcdBarrier xcd_barrier_post(unsigned* bar, volatile LAS unsigned* st) {
    XcdBarrier b; b.bar = bar; b.x = xb_xcc_id(); b.st = st;
    if (threadIdx.x == 0) (void)xb_add(&bar[XB_XCNT(b.x)], 1u);
    return b;
}
__device__ __forceinline__ void xcd_barrier_complete(unsigned* bar, unsigned x, unsigned& nloc, unsigned& nx) {
    const unsigned G = gridDim.x * gridDim.y * gridDim.z;
    unsigned sum, cnt, mine, sp = 0u;
    for (;;) {
        sum = 0u; cnt = 0u; mine = 0u;
#pragma unroll
        for (unsigned j = 0; j < 16; ++j) { const unsigned c = xb_ld(&bar[XB_XCNT(j)]); sum += c; cnt += (c > 0u) ? 1u : 0u; mine = (j == x) ? c : mine; }
        if (sum == G) break;
        __builtin_amdgcn_s_sleep(1);
        if ((++sp & 255u) == 0u) { if (xb_ld(&bar[XB_TMO])) break; if (sp > XB_SPIN_CAP) { atomicAdd(&bar[XB_TMO], 1u); break; } }
    }
    nloc = mine > 0u ? mine : 1u; nx = cnt > 0u ? cnt : 1u;
}

__device__ __forceinline__ void xcd_barrier(const XcdBarrier& b) {
    asm volatile("s_waitcnt vmcnt(0)" ::: "memory");
    __syncthreads();
    if (threadIdx.x == 0) {
        unsigned* bar = b.bar;
        __builtin_amdgcn_s_waitcnt(0);
        unsigned nloc = b.st[0], nx = b.st[1];
        if (nloc == 0u) { xcd_barrier_complete(bar, b.x, nloc, nx); b.st[0] = nloc; b.st[1] = nx; }
        const unsigned old = xb_add(&bar[XB_XSUB(b.x)], 1u);
        const unsigned gen = old / nloc;
        if (old + 1u == (gen + 1u) * nloc) {
            __builtin_amdgcn_fence(__ATOMIC_RELEASE, "agent");
            asm volatile("s_waitcnt vmcnt(0)" ::: "memory");
            const unsigned og = xb_add(&bar[XB_TOP], 1u);
            const unsigned tg = og / nx;
            if (og + 1u == (tg + 1u) * nx) xb_add(&bar[XB_TOPGEN], 1u);
            else XB_SPIN(xb_ld(&bar[XB_TOPGEN]) == tg, bar);
            __builtin_amdgcn_fence(__ATOMIC_ACQUIRE, "agent");
            xb_add(&bar[XB_XGEN(b.x)], 1u);
            asm volatile("s_waitcnt vmcnt(0)" ::: "memory");
        } else {
            XB_SPIN(xb_ld(&bar[XB_XGEN(b.x)]) == gen, bar);
            __builtin_amdgcn_fence(__ATOMIC_ACQUIRE, "agent");
            asm volatile("s_waitcnt vmcnt(0)" ::: "memory");
        }
    }
    __syncthreads();
}
constexpr int NWAVES = 8;
constexpr size_t MiB = 1u << 20;
constexpr size_t WS_CTL = 0, CTL_ZERO_BYTES = 1 * MiB;
constexpr size_t WS_WIN = 1 * MiB, WS_WUQ = 5 * MiB, WS_WUKV = 6 * MiB, WS_WO = 7 * MiB, WS_WUP = 9 * MiB, WS_WDN = 20 * MiB;
constexpr size_t WS_ROPEA = 26 * MiB, WS_ROPEB = 28 * MiB;
constexpr size_t WS_SSQQ = 36 * MiB, WS_SSQKV = 36 * MiB + 512 * 1024, WS_SSQO = 37 * MiB;
constexpr size_t WS_XCH = 39 * MiB;
constexpr size_t WS_HALO = 41 * MiB;
constexpr size_t WS_XN = 56 * MiB;
constexpr size_t WS_QA = 120 * MiB, WS_KA = 152 * MiB, WS_VA = 184 * MiB, WS_CQ = 216 * MiB, WS_CKV = 232 * MiB, WS_KPE = 240 * MiB;
constexpr size_t WS_QB = 244 * MiB, WS_KVB = 292 * MiB, WS_O = 356 * MiB, WS_SWS = 420 * MiB, WS_SWL = 484 * MiB;
constexpr size_t WS_ACT = 120 * MiB;
constexpr size_t WS_END = 486 * MiB;
constexpr int CW_TMO = 0, CW_CODE = 1, CW_BAR = 4096, CW_SEAM = 16384, SEAM_BANK = 128 * 64;
constexpr int RING_OFF = 0, RING_BYTES = 131072, LDSCTL_OFF = RING_BYTES, MISC_OFF = LDSCTL_OFF + 320, LDS_BYTES = 147456;

struct Frame {
    LAS unsigned char* lds; volatile LAS unsigned* MISC; gu32* ctl;
    int tid, lane, wave, vcu, G;
};
__device__ __forceinline__ float wave_sum(float v) {
#pragma unroll
    for (int o = 1; o < 64; o <<= 1) v += __shfl_xor(v, o);
    return v;
}
__device__ __forceinline__ int rope_perm(int p, int half) { const int a = p >> 3, s = p & 7; return s < 4 ? 4 * a + s : 4 * a + (s - 4) + half; }
__device__ __forceinline__ int map_col(int kind, int rho) {
    switch (kind) {
    case 0: { if (rho < 1024) { const int p = rho & 63; return (rho & ~63) + (p < 16 ? rope_perm(p, 8) : p); }
              if (rho < 1920) return rho; if (rho < 1984) return 1920 + rope_perm(rho - 1920, 32); return -1; }
    case 1: { const int hh = rho / 192, w = rho % 192; return w < 128 ? rho : hh * 192 + 128 + rope_perm(w - 128, 32); }
    case 3: { const int pn = rho >> 8, j = rho & 255; return j < 128 ? 128 * pn + j : FF + 128 * pn + (j - 128); }
    default: return rho; }
}
__device__ __forceinline__ void p0_item(const float* W, int K, int N, bf16* WT, int nrows, int kind, const float* gain, LAS float* scr, int item, int lane) {
    const int nblk = nrows / 32, kb = item / nblk, nb = item % nblk, k0 = 64 * kb, r0 = 32 * nb;
    const int src = map_col(kind, r0 + (lane & 31));
#pragma unroll 8
    for (int i = 0; i < 32; ++i) { const int kk = 2 * i + (lane >> 5); float v = src >= 0 ? W[(size_t)(k0 + kk) * N + src] : 0.f; if (gain) v *= gain[k0 + kk]; scr[kk * 33 + (lane & 31)] = v; }
    LDS_WAIT(); asm volatile("" ::: "memory");
    const int c = lane & 7;
#pragma unroll
    for (int j = 0; j < 4; ++j) { const int n = (lane >> 3) + 8 * j; const LAS float* s = scr + (8 * c) * 33 + n;
        v4u o; o.x = pk2(s[0 * 33], s[1 * 33]); o.y = pk2(s[2 * 33], s[3 * 33]); o.z = pk2(s[4 * 33], s[5 * 33]); o.w = pk2(s[6 * 33], s[7 * 33]);
        *(GAS v4u*)(WT + (size_t)(r0 + n) * K + k0 + 8 * c) = o; }
    LDS_WAIT(); asm volatile("" ::: "memory");
}
struct Args { const void* in[19]; float* out; unsigned char* ws; int ph_lo, ph_hi, li, pad; };

__device__ __forceinline__ void p0_prologue(Frame& F, const Args& A) {
    unsigned char* ws = A.ws;
    LAS float* scr = (LAS float*)(F.lds + RING_OFF + F.wave * 16384);
    const int gw = F.vcu * NWAVES + F.wave, NGW = F.G * NWAVES;
    constexpr int I0 = (INWP / 32) * (D / 64), I1 = (768 / 32) * (256 / 64), I2 = (1024 / 32) * (128 / 64), I3 = (D / 32) * (1024 / 64), I4 = (FF2 / 32) * (D / 64), I5 = (D / 32) * (FF / 64);
    constexpr int NITEMS = I0 + I1 + I2 + I3 + I4 + I5;
    for (int it = gw; it < NITEMS; it += NGW) {
        int r = it;
        if (r < I0) { p0_item((const float*)A.in[4], D, INW, (bf16*)(ws + WS_WIN), INWP, 0, nullptr, scr, r, F.lane); continue; } r -= I0;
        if (r < I1) { p0_item((const float*)A.in[6], 256, 768, (bf16*)(ws + WS_WUQ), 768, 1, (const float*)A.in[5], scr, r, F.lane); continue; } r -= I1;
        if (r < I2) { p0_item((const float*)A.in[8], 128, 1024, (bf16*)(ws + WS_WUKV), 1024, 2, (const float*)A.in[7], scr, r, F.lane); continue; } r -= I2;
        if (r < I3) { p0_item((const float*)A.in[10], 1024, D, (bf16*)(ws + WS_WO), D, 2, (const float*)A.in[9], scr, r, F.lane); continue; } r -= I3;
        if (r < I4) { p0_item((const float*)A.in[13], D, FF2, (bf16*)(ws + WS_WUP), FF2, 3, nullptr, scr, r, F.lane); continue; } r -= I4;
        p0_item((const float*)A.in[16], FF, D, (bf16*)(ws + WS_WDN), D, 2, nullptr, scr, r, F.lane);
    }
    { const float* x = (const float*)A.in[0]; const float* g = (const float*)A.in[2]; const float* b = (const float*)A.in[3]; bf16* XN = (bf16*)(ws + WS_XN);
      f32x4 gv[4], bv[4];
#pragma unroll
      for (int j = 0; j < 4; ++j) { gv[j] = ((const f32x4*)g)[F.lane + 64 * j]; bv[j] = ((const f32x4*)b)[F.lane + 64 * j]; }
      for (int m = gw; m < M; m += NGW) {
        const GAS f32x4* xr = (const GAS f32x4*)(x + (size_t)m * D) + F.lane;
        f32x4 v[4]; float s = 0.f;
#pragma unroll
        for (int j = 0; j < 4; ++j) { v[j] = xr[64 * j]; s += (v[j].x + v[j].y) + (v[j].z + v[j].w); }
        const float mean = wave_sum(s) * (1.f / D); float s2 = 0.f;
#pragma unroll
        for (int j = 0; j < 4; ++j) { v[j] = v[j] - mean; s2 += (v[j].x * v[j].x + v[j].y * v[j].y) + (v[j].z * v[j].z + v[j].w * v[j].w); }
        const float rstd = 1.f / sqrtf(wave_sum(s2) * (1.f / D) + LN_EPS);
        GAS unsigned long long* o8 = (GAS unsigned long long*)(XN + (size_t)m * D) + F.lane;
#pragma unroll
        for (int j = 0; j < 4; ++j) { const f32x4 y = v[j] * rstd * gv[j] + bv[j]; o8[64 * j] = (unsigned long long)pk2(y.x, y.y) | ((unsigned long long)pk2(y.z, y.w) << 32); }
      } }
    { const int* pos = (const int*)A.in[1]; float* RA = (float*)(ws + WS_ROPEA); float* RB = (float*)(ws + WS_ROPEB);
      const int gt = F.vcu * (NWAVES * 64) + F.tid, NT = F.G * NWAVES * 64;
      for (int idx = gt; idx < M * 40; idx += NT) { const int t = idx / 40, i = idx % 40;
        const float inv = (i < 8) ? exp2f(-(float)i * (2.0f / 16.0f) * LOG2_THETA) : exp2f(-(float)(i - 8) * (2.0f / 64.0f) * LOG2_THETA);
        const float ang = (float)pos[t] * inv; float sn, cs; sincosf(ang, &sn, &cs);
        if (i < 8) { RA[(size_t)t * 16 + i] = cs; RA[(size_t)t * 16 + 8 + i] = sn; } else { RB[(size_t)t * 64 + (i - 8)] = cs; RB[(size_t)t * 64 + 32 + (i - 8)] = sn; } } }
}

constexpr int N_PHASES = 8;
__global__ void __launch_bounds__(NWAVES * 64, 2) mk_fwd(Args args) {
    extern __shared__ __attribute__((aligned(16))) unsigned char lds[];
    Frame F;
    F.lds = (LAS unsigned char*)lds; F.MISC = (volatile LAS unsigned*)(F.lds + MISC_OFF);
    F.tid = threadIdx.x; F.lane = F.tid & 63; F.wave = __builtin_amdgcn_readfirstlane(F.tid >> 6);
    F.G = gridDim.x; { const int bx = blockIdx.x; F.vcu = (F.G % 8 == 0) ? (bx % 8) * (F.G / 8) + bx / 8 : bx; }
    unsigned char* ws = args.ws;
    F.ctl = (gu32*)(ws + WS_CTL);
    for (int u = F.tid; u < (LDS_BYTES - LDSCTL_OFF) / 4; u += NWAVES * 64) ((LAS unsigned*)(F.lds + LDSCTL_OFF))[u] = 0u;
    __syncthreads();
    const bool one_launch = (args.ph_hi - args.ph_lo) > 1;
    XcdBarrier bar; bar.bar = (unsigned*)(F.ctl + CW_BAR); bar.x = 0; bar.st = nullptr;
    if (one_launch) bar = xcd_barrier_post((unsigned*)(F.ctl + CW_BAR), F.MISC + 8);
    const int lo = args.ph_lo, hi = args.ph_hi;
#define IN(k) (lo <= (k) && (k) < hi)
#define SEAM(k) do { if (IN(k) && IN((k) + 1)) xcd_barrier(bar); } while (0)
    if (IN(0)) { p0_prologue(F, args); SEAM(0); }
    if (IN(1)) {
        pg8::Gemm g{(const pg8::bf16_t*)(ws + WS_XN), (const pg8::bf16_t*)(ws + WS_WIN), M, INWP, D}; pg8::StaticOrder So; So.init(M, INWP, F.G, (int)blockIdx.x);
        pg8::EpiIn E{(pg8::bf16_t*)(ws + WS_QA), (pg8::bf16_t*)(ws + WS_KA), (pg8::bf16_t*)(ws + WS_VA), (pg8::bf16_t*)(ws + WS_CQ), (pg8::bf16_t*)(ws + WS_CKV), (pg8::bf16_t*)(ws + WS_KPE),
                     (float*)(ws + WS_SSQQ), (float*)(ws + WS_SSQKV), (const float*)(ws + WS_ROPEA), (const float*)(ws + WS_ROPEB)};
        pg8::gemm_phase<pg8::EpiIn, pg8::StaticOrder, true, true>(F.lds + RING_OFF, g, So, E);
        SEAM(1);
    }
    if (IN(2)) {
        { pg8::Gemm g{(const pg8::bf16_t*)(ws + WS_CQ), (const pg8::bf16_t*)(ws + WS_WUQ), M, 768, 256}; pg8::StaticOrder So; So.init(M, 768, F.G, (int)blockIdx.x);
          pg8::EpiQb E{(pg8::bf16_t*)(ws + WS_QB), (const float*)(ws + WS_SSQQ), (const float*)(ws + WS_ROPEB)};
          pg8::gemm_phase<pg8::EpiQb, pg8::StaticOrder, true, true>(F.lds + RING_OFF, g, So, E); }
        { pg8::Gemm g{(const pg8::bf16_t*)(ws + WS_CKV), (const pg8::bf16_t*)(ws + WS_WUKV), M, 1024, 128}; pg8::StaticOrder So; So.init(M, 1024, F.G, (int)blockIdx.x);
          pg8::EpiKv E{(pg8::bf16_t*)(ws + WS_KVB), (const float*)(ws + WS_SSQKV)};
          pg8::gemm_phase<pg8::EpiKv, pg8::StaticOrder, true, true>(F.lds + RING_OFF, g, So, E); }
        SEAM(2);
    }
#undef IN
#undef SEAM
}

__device__ __forceinline__ float bf2f(bf16 v) { return __uint_as_float((unsigned)v << 16); }
__device__ __forceinline__ bf16 f2bf_rne(float f) { return (bf16)f2bf(f); }
__global__ void __launch_bounds__(64) swa_naive(const bf16* __restrict__ QA, const bf16* __restrict__ KA, const bf16* __restrict__ VA, bf16* __restrict__ O, float* __restrict__ ssq_o) {
    const int s = blockIdx.x * 64 + threadIdx.x, hh = blockIdx.y, b = blockIdx.z; const size_t rb = (size_t)b * S;
    float q[64];
#pragma unroll
    for (int i = 0; i < 64; ++i) q[i] = bf2f(QA[(rb + s) * 512 + hh * 64 + i]);
    float outv[64];
#pragma unroll
    for (int i = 0; i < 64; ++i) outv[i] = 0.f;
    float lse_run = -INFINITY, wsum = 0.f;
    for (int p = 0; p < 3; ++p) {
        const int d = (p == 0) ? 1 : (p == 1) ? 4 : 16; const int L = S / d, n = s / d;
        float m = -INFINITY, den = 0.f, acc[64];
#pragma unroll
        for (int i = 0; i < 64; ++i) acc[i] = 0.f;
        for (int j = -64; j <= 64; ++j) {
            const int kn = n + j; if (kn < 0 || kn >= L) continue;
            const size_t kr = rb + s + j * d;
            float sc = 0.f;
#pragma unroll
            for (int i = 0; i < 64; ++i) sc = fmaf(q[i], bf2f(KA[kr * 512 + hh * 64 + i]), sc);
            const float mn = fmaxf(m, sc); const float f = exp2f(m - mn), pe = exp2f(sc - mn);
            den = den * f + pe;
#pragma unroll
            for (int i = 0; i < 64; ++i) acc[i] = acc[i] * f + pe * bf2f(VA[kr * 512 + hh * 64 + i]);
            m = mn;
        }
        const float lse = m + log2f(den);
        const float ln = fmaxf(lse_run, lse); const float f_old = exp2f(lse_run - ln), f_new = exp2f(lse - ln);
        wsum = wsum * f_old + f_new; const float sc_new = f_new / den;
#pragma unroll
        for (int i = 0; i < 64; ++i) outv[i] = outv[i] * f_old + acc[i] * sc_new;
        lse_run = ln;
    }
    const float inv = 1.f / wsum; float ss = 0.f;
#pragma unroll
    for (int i = 0; i < 64; ++i) { const float v = outv[i] * inv; ss += v * v; O[(rb + s) * 1024 + hh * 64 + i] = f2bf_rne(v); }
    ssq_o[(rb + s) * 12 + hh] = ss;
}
__global__ void __launch_bounds__(256) mla_naive(const bf16* __restrict__ QB, const bf16* __restrict__ KVB, const bf16* __restrict__ KPE, bf16* __restrict__ O, float* __restrict__ ssq_o) {
    const int sub = threadIdx.x & 3, s = blockIdx.x * 64 + (threadIdx.x >> 2), hh = blockIdx.y, b = blockIdx.z; const size_t rb = (size_t)b * S;
    float q[48];
#pragma unroll
    for (int i = 0; i < 32; ++i) q[i] = bf2f(QB[(rb + s) * 768 + hh * 192 + sub * 32 + i]);
#pragma unroll
    for (int i = 0; i < 16; ++i) q[32 + i] = bf2f(QB[(rb + s) * 768 + hh * 192 + 128 + sub * 16 + i]);
    float m = -INFINITY, den = 0.f, acc[32];
#pragma unroll
    for (int i = 0; i < 32; ++i) acc[i] = 0.f;
    for (int j = 0; j < S; ++j) {
        const bf16* kp = KVB + (rb + j) * 1024 + hh * 256 + sub * 32; const bf16* pp = KPE + (rb + j) * 64 + sub * 16; const bf16* vp = kp + 128;
        float sc = 0.f;
#pragma unroll
        for (int i = 0; i < 32; ++i) sc = fmaf(q[i], bf2f(kp[i]), sc);
#pragma unroll
        for (int i = 0; i < 16; ++i) sc = fmaf(q[32 + i], bf2f(pp[i]), sc);
        sc += __shfl_xor(sc, 1); sc += __shfl_xor(sc, 2);
        sc *= QSC_B;
        const float mn = fmaxf(m, sc); const float f = exp2f(m - mn), pe = exp2f(sc - mn);
        den = den * f + pe;
#pragma unroll
        for (int i = 0; i < 32; ++i) acc[i] = acc[i] * f + pe * bf2f(vp[i]);
        m = mn;
    }
    const float inv = 1.f / den; float ss = 0.f;
#pragma unroll
    for (int i = 0; i < 32; ++i) { const float v = acc[i] * inv; ss += v * v; O[(rb + s) * 1024 + 512 + hh * 128 + sub * 32 + i] = f2bf_rne(v); }
    ss += __shfl_xor(ss, 1); ss += __shfl_xor(ss, 2);
    if (sub == 0) ssq_o[(rb + s) * 12 + 8 + hh] = ss;
}
__global__ void cvt_bf16_f32(const bf16* in, float* out, size_t n) { for (size_t i = blockIdx.x * (size_t)blockDim.x + threadIdx.x; i < n; i += (size_t)gridDim.x * blockDim.x) out[i] = bf2f(in[i]); }
__global__ void __launch_bounds__(256) gemm_f32(const float* __restrict__ A, int lda, const float* __restrict__ Bm, int ldb, float* __restrict__ C, int ldc, int K) {
    __shared__ float As[16][65];
    __shared__ float Bs[16][64];
    const int tx = threadIdx.x & 15, ty = threadIdx.x >> 4;
    const int m0 = blockIdx.y * 64, n0 = blockIdx.x * 64;
    float acc[4][4];
#pragma unroll
    for (int i = 0; i < 4; ++i)
#pragma unroll
        for (int j = 0; j < 4; ++j) acc[i][j] = 0.f;
    for (int k0 = 0; k0 < K; k0 += 16) {
        { const int r = threadIdx.x >> 2, c4 = (threadIdx.x & 3) * 4; const float4 v = *(const float4*)(A + (size_t)(m0 + r) * lda + k0 + c4);
          As[c4 + 0][r] = v.x; As[c4 + 1][r] = v.y; As[c4 + 2][r] = v.z; As[c4 + 3][r] = v.w; }
        { const int r = threadIdx.x >> 4, c4 = (threadIdx.x & 15) * 4; *(float4*)&Bs[r][c4] = *(const float4*)(Bm + (size_t)(k0 + r) * ldb + n0 + c4); }
        __syncthreads();
#pragma unroll
        for (int kk = 0; kk < 16; ++kk) { float a[4], b[4];
#pragma unroll
            for (int i = 0; i < 4; ++i) a[i] = As[kk][ty * 4 + i];
#pragma unroll
            for (int j = 0; j < 4; ++j) b[j] = Bs[kk][tx * 4 + j];
#pragma unroll
            for (int i = 0; i < 4; ++i)
#pragma unroll
                for (int j = 0; j < 4; ++j) acc[i][j] = fmaf(a[i], b[j], acc[i][j]); }
        __syncthreads();
    }
#pragma unroll
    for (int i = 0; i < 4; ++i) { float4 v = {acc[i][0], acc[i][1], acc[i][2], acc[i][3]}; *(float4*)(C + (size_t)(m0 + ty * 4 + i) * ldc + n0 + tx * 4) = v; }
}
__device__ __forceinline__ float block_sum(float v, float* red) {
#pragma unroll
    for (int o = 32; o > 0; o >>= 1) v += __shfl_xor(v, o);
    const int w = threadIdx.x >> 6;
    __syncthreads();
    if ((threadIdx.x & 63) == 0) red[w] = v;
    __syncthreads();
    return red[0] + red[1] + red[2] + red[3];
}
__global__ void __launch_bounds__(256) ln_kernel(const float* x, const float* res, float alpha, const float* g, const float* b, float* out) {
    __shared__ float red[4];
    const size_t row = blockIdx.x; const int c = threadIdx.x * 4;
    float4 v = *(const float4*)(x + row * D + c);
    if (res) { const float4 r = *(const float4*)(res + row * D + c); v.x += alpha * r.x; v.y += alpha * r.y; v.z += alpha * r.z; v.w += alpha * r.w; }
    const float mean = block_sum(v.x + v.y + v.z + v.w, red) * (1.f / D);
    v.x -= mean; v.y -= mean; v.z -= mean; v.w -= mean;
    const float var = block_sum(v.x * v.x + v.y * v.y + v.z * v.z + v.w * v.w, red) * (1.f / D);
    const float rstd = 1.0f / sqrtf(var + LN_EPS);
    const float4 gg = *(const float4*)(g + c), bb = *(const float4*)(b + c);
    float4 o = {v.x * rstd * gg.x + bb.x, v.y * rstd * gg.y + bb.y, v.z * rstd * gg.z + bb.z, v.w * rstd * gg.w + bb.w};
    *(float4*)(out + row * D + c) = o;
}
__global__ void __launch_bounds__(256) rms_kernel(const float* in, int ldi, int ic, const float* g, float* out, int ldo, int oc, int w) {
    __shared__ float red[4];
    const size_t row = blockIdx.x; float ss = 0.f;
    for (int i = threadIdx.x; i < w; i += 256) { const float v = in[row * ldi + ic + i]; ss += v * v; }
    const float rstd = 1.0f / sqrtf(block_sum(ss, red) / (float)w + RMS_EPS);
    for (int i = threadIdx.x; i < w; i += 256) out[row * ldo + oc + i] = in[row * ldi + ic + i] * rstd * g[i];
}
__global__ void conv_act_kernel(const float* __restrict__ u, const float* __restrict__ cw, const float* __restrict__ cb, float* __restrict__ act) {
    const int c = blockIdx.x * blockDim.x + threadIdx.x; const int s = blockIdx.y;
    if (c >= FF) return;
    float g = cb[c], v = cb[FF + c];
#pragma unroll
    for (int t = 0; t < 3; ++t) { const int ss = s + t - 1; if (ss < 0 || ss >= S) continue;
        g = fmaf(u[(size_t)ss * FF2 + c], cw[t * FF2 + c], g); v = fmaf(u[(size_t)ss * FF2 + FF + c], cw[t * FF2 + FF + c], v); }
    act[(size_t)s * FF + c] = g / (1.f + __expf(-g)) * v;
}
static void gemm(const float* A, int lda, const float* Bm, int ldb, float* C, int ldc, int Mr, int N, int K, hipStream_t st) {
    hipLaunchKernelGGL(gemm_f32, dim3(N / 64, Mr / 64), dim3(256), 0, st, A, lda, Bm, ldb, C, ldc, K);
}
extern "C" void kernel_launch(void* const* d_in, const int* in_sizes, int n_in, void* d_out, int out_size, void* d_ws, size_t ws_size, hipStream_t stream) {
    static int grid = 0;
    if (grid == 0) {
        if (n_in != 19 || in_sizes[0] != M * D || out_size != M * D || ws_size < WS_END) { fprintf(stderr, "kernel_launch: shape/workspace mismatch (n_in %d, in0 %d, out %d, ws %zu)\n", n_in, n_in > 0 ? in_sizes[0] : -1, out_size, ws_size); grid = -1; return; }
        int dev = 0, cus = 0;
        if (hipGetDevice(&dev) != hipSuccess || hipDeviceGetAttribute(&cus, hipDeviceAttributeMultiprocessorCount, dev) != hipSuccess) { grid = -1; return; }
        if (hipFuncSetAttribute((const void*)mk_fwd, hipFuncAttributeMaxDynamicSharedMemorySize, LDS_BYTES) != hipSuccess) { fprintf(stderr, "kernel_launch: hipFuncSetAttribute failed\n"); grid = -1; return; }
        grid = cus;
    }
    if (grid < 0) return;
    unsigned char* ws = (unsigned char*)d_ws;
    hipMemsetAsync(ws + WS_CTL, 0, CTL_ZERO_BYTES, stream);
    Args a{};
    for (int i = 0; i < 19; ++i) a.in[i] = d_in[i];
    a.out = (float*)d_out; a.ws = ws;
    for (int ph = 0; ph < 3; ++ph) { a.ph_lo = ph; a.ph_hi = ph + 1; a.li = 0; hipLaunchKernelGGL(mk_fwd, dim3(grid), dim3(NWAVES * 64), LDS_BYTES, stream, a); }
    bf16* O = (bf16*)(ws + WS_O); float* ssq_o = (float*)(ws + WS_SSQO);
    hipLaunchKernelGGL(swa_naive, dim3(S / 64, 8, NB), dim3(64), 0, stream, (const bf16*)(ws + WS_QA), (const bf16*)(ws + WS_KA), (const bf16*)(ws + WS_VA), O, ssq_o);
    hipLaunchKernelGGL(mla_naive, dim3(S / 64, 4, NB), dim3(256), 0, stream, (const bf16*)(ws + WS_QB), (const bf16*)(ws + WS_KVB), (const bf16*)(ws + WS_KPE), O, ssq_o);
    const float* out_norm_g = (const float*)d_in[9]; const float* w_o = (const float*)d_in[10]; const float* ln1_g = (const float*)d_in[11]; const float* ln1_b = (const float*)d_in[12];
    const float* w_up = (const float*)d_in[13]; const float* conv_w = (const float*)d_in[14]; const float* conv_b = (const float*)d_in[15];
    const float* w_down = (const float*)d_in[16]; const float* ln2_g = (const float*)d_in[17]; const float* ln2_b = (const float*)d_in[18];
    float* sc = (float*)(ws + 120 * MiB);
    float* x0 = sc; float* ob = x0 + (size_t)S * D; float* on = ob + (size_t)S * D; float* tb = on + (size_t)S * D; float* ub = tb + (size_t)S * D; float* actb = ub + (size_t)S * FF2;
    float* out = (float*)d_out;
    for (int b = 0; b < NB; ++b) {
        float* outb = out + (size_t)b * S * D;
        hipLaunchKernelGGL(cvt_bf16_f32, dim3(2048), dim3(256), 0, stream, (const bf16*)(ws + WS_XN) + (size_t)b * S * D, x0, (size_t)S * D);
        hipLaunchKernelGGL(cvt_bf16_f32, dim3(2048), dim3(256), 0, stream, (const bf16*)O + (size_t)b * S * D, ob, (size_t)S * D);
        hipLaunchKernelGGL(rms_kernel, dim3(S), dim3(256), 0, stream, ob, 1024, 0, out_norm_g, on, 1024, 0, 512);
        hipLaunchKernelGGL(rms_kernel, dim3(S), dim3(256), 0, stream, ob, 1024, 512, out_norm_g + 512, on, 1024, 512, 512);
        gemm(on, 1024, w_o, D, tb, D, S, D, 1024, stream);
        hipLaunchKernelGGL(ln_kernel, dim3(S), dim3(256), 0, stream, tb, x0, ALPHA, ln1_g, ln1_b, outb);
        gemm(outb, D, w_up, FF2, ub, FF2, S, FF2, D, stream);
        hipLaunchKernelGGL(conv_act_kernel, dim3((FF + 255) / 256, S), dim3(256), 0, stream, ub, conv_w, conv_b, actb);
        gemm(actb, FF, w_down, D, tb, D, S, D, FF, stream);
        hipLaunchKernelGGL(ln_kernel, dim3(S), dim3(256), 0, stream, tb, outb, ALPHA, ln2_g, ln2_b, outb);
    }
}
```
